# Optimizing an MI355X kernel written in HIP

```python
import math
import jax, jax.numpy as jnp
from jax import lax
import numpy as np

D_MODEL = 2048
BATCH = 8
SEQ = 2048
DEPTH = 1

SSM_WIDTH = D_MODEL // 2
SSM_GROUP = 16
SSM_GROUPS = SSM_WIDTH // SSM_GROUP
SSM_STATE = 64
DT_MIN = 0.001
DT_MAX = 0.1
ATTN_HEADS = 8
HEAD_DIM = 128
ATTN_WIDTH = ATTN_HEADS * HEAD_DIM
MOBA_BLOCK = 256
MOBA_TOPK = 3
Q_BLOCK = 128
REL_BUCKETS = 32
REL_MAX_DIST = 128
D_FF = 4 * D_MODEL
N_MOD = 6
EPS = 1e-6
NEG_INF = -1e30
IN_WIDTH = SSM_WIDTH + 3 * ATTN_WIDTH + 2 * D_MODEL

kernel_name = "hybrid_s5_moba_gated_block"


def rms_norm(x, g):
    x32 = x.astype(jnp.float32)
    y = x32 * lax.rsqrt(jnp.mean(x32 * x32, axis=-1, keepdims=True) + EPS)
    return (y * g.astype(jnp.float32)).astype(x.dtype)


def _ssm_combine(lhs, rhs):
    a_re1, a_im1, b_re1, b_im1 = lhs
    a_re2, a_im2, b_re2, b_im2 = rhs
    a_re = a_re2 * a_re1 - a_im2 * a_im1
    a_im = a_re2 * a_im1 + a_im2 * a_re1
    b_re = a_re2 * b_re1 - a_im2 * b_im1 + b_re2
    b_im = a_re2 * b_im1 + a_im2 * b_re1 + b_im2
    return (a_re, a_im, b_re, b_im)


def s5_branch(u, a_re, a_im, log_dt, b_re, b_im, c_re, c_im, d_skip, w_glu, b_glu):
    bsz, seq_len, _ = u.shape
    f32 = jnp.float32
    u32 = u.astype(f32).reshape(bsz, seq_len, SSM_GROUPS, SSM_GROUP)
    a_re = a_re.astype(f32)
    a_im = a_im.astype(f32)
    dt = jnp.exp(log_dt.astype(f32))[:, None]
    mag = jnp.exp(dt * a_re)
    abar_re = mag * jnp.cos(dt * a_im)
    abar_im = mag * jnp.sin(dt * a_im)
    den = a_re * a_re + a_im * a_im
    p_re = abar_re - 1.0
    f_re = (p_re * a_re + abar_im * a_im) / den
    f_im = (abar_im * a_re - p_re * a_im) / den
    b_re = b_re.astype(f32)
    b_im = b_im.astype(f32)
    bbar_re = f_re[..., None] * b_re - f_im[..., None] * b_im
    bbar_im = f_re[..., None] * b_im + f_im[..., None] * b_re
    bu_re = jnp.einsum('blgp,gnp->blgn', u32, bbar_re)
    bu_im = jnp.einsum('blgp,gnp->blgn', u32, bbar_im)
    a_seq_re = jnp.broadcast_to(abar_re, bu_re.shape)
    a_seq_im = jnp.broadcast_to(abar_im, bu_im.shape)
    _, _, s_re, s_im = lax.associative_scan(
        _ssm_combine, (a_seq_re, a_seq_im, bu_re, bu_im), axis=1)
    y = (jnp.einsum('blgn,gpn->blgp', s_re, c_re.astype(f32))
         - jnp.einsum('blgn,gpn->blgp', s_im, c_im.astype(f32)))
    y = y.reshape(bsz, seq_len, SSM_WIDTH) + d_skip.astype(f32) * u32.reshape(bsz, seq_len, SSM_WIDTH)
    y = jax.nn.gelu(y).astype(u.dtype)
    return y * jax.nn.sigmoid(y @ w_glu + b_glu)


def t5_bucket(rel):
    n = jnp.maximum(rel, 0)
    max_exact = REL_BUCKETS // 2
    nf = jnp.maximum(n, 1).astype(jnp.float32)
    large = max_exact + (jnp.log(nf / max_exact) / math.log(REL_MAX_DIST / max_exact)
                         * (REL_BUCKETS - max_exact)).astype(jnp.int32)
    large = jnp.minimum(large, REL_BUCKETS - 1)
    return jnp.where(n < max_exact, n, large)


def moba_attention(q, k, v, rel_bias):
    bsz, seq_len = q.shape[0], q.shape[1]
    n_blk = -(-seq_len // MOBA_BLOCK)
    pad = n_blk * MOBA_BLOCK - seq_len
    n_sel = min(MOBA_TOPK, n_blk - 1)
    q = q.transpose(0, 2, 1, 3)
    k = jnp.pad(k.transpose(0, 2, 1, 3), ((0, 0), (0, 0), (0, pad), (0, 0)))
    v = jnp.pad(v.transpose(0, 2, 1, 3), ((0, 0), (0, 0), (0, pad), (0, 0)))
    kb = k.reshape(bsz, ATTN_HEADS, n_blk, MOBA_BLOCK, HEAD_DIM)
    vb = v.reshape(bsz, ATTN_HEADS, n_blk, MOBA_BLOCK, HEAD_DIM)
    kmean = jnp.mean(kb.astype(jnp.float32), axis=3).astype(k.dtype)
    bias_table = rel_bias.T
    head_ix = jnp.arange(ATTN_HEADS)
    n_qblk = seq_len // Q_BLOCK
    scale = HEAD_DIM ** -0.5
    blk_off = jnp.arange(MOBA_BLOCK)

    def one_block(i):
        b = i // n_qblk
        q0 = (i % n_qblk) * Q_BLOCK
        own = q0 // MOBA_BLOCK
        qc = lax.dynamic_slice_in_dim(lax.dynamic_index_in_dim(q, b, 0, keepdims=False),
                                      q0, Q_BLOCK, axis=1)
        kb_b = lax.dynamic_index_in_dim(kb, b, 0, keepdims=False)
        vb_b = lax.dynamic_index_in_dim(vb, b, 0, keepdims=False)
        q_pos = q0 + jnp.arange(Q_BLOCK)
        k_own = lax.dynamic_index_in_dim(kb_b, own, 1, keepdims=False)
        v_own = lax.dynamic_index_in_dim(vb_b, own, 1, keepdims=False)
        rel_own = q_pos[:, None] - (own * MOBA_BLOCK + blk_off)[None, :]
        s_own = (jnp.einsum('hqd,hsd->hqs', qc, k_own).astype(jnp.float32) * scale
                 + bias_table[:, t5_bucket(rel_own)].astype(jnp.float32))
        s_own = jnp.where(rel_own[None] >= 0, s_own, NEG_INF)
        if n_sel == 0:
            p = jax.nn.softmax(s_own, axis=-1).astype(v.dtype)
            return jnp.einsum('hqs,hsd->hqd', p, v_own)
        gate = jnp.einsum('hqd,hnd->hqn', qc, kmean[b]).astype(jnp.float32)
        gate = jnp.where(jnp.arange(n_blk) < own, gate, NEG_INF)
        _, sel = lax.top_k(gate, n_sel)
        valid = jnp.arange(n_sel) < own
        kg = kb_b[head_ix[:, None, None], sel]
        vg = vb_b[head_ix[:, None, None], sel]
        rel_sel = q_pos[None, :, None, None] - (sel[..., None] * MOBA_BLOCK + blk_off)
        s_sel = (jnp.einsum('hqd,hqksd->hqks', qc, kg).astype(jnp.float32) * scale
                 + bias_table[head_ix[:, None, None, None], t5_bucket(rel_sel)].astype(jnp.float32))
        s_sel = jnp.where(valid[None, None, :, None], s_sel, NEG_INF)
        s = jnp.concatenate([s_sel.reshape(ATTN_HEADS, Q_BLOCK, n_sel * MOBA_BLOCK), s_own], axis=-1)
        p = jax.nn.softmax(s, axis=-1).astype(v.dtype)
        p_sel = p[..., :n_sel * MOBA_BLOCK].reshape(ATTN_HEADS, Q_BLOCK, n_sel, MOBA_BLOCK)
        return (jnp.einsum('hqks,hqksd->hqd', p_sel, vg)
                + jnp.einsum('hqs,hsd->hqd', p[..., n_sel * MOBA_BLOCK:], v_own))

    o = lax.map(one_block, jnp.arange(bsz * n_qblk))
    o = o.reshape(bsz, n_qblk, ATTN_HEADS, Q_BLOCK, HEAD_DIM).transpose(0, 1, 3, 2, 4)
    return o.reshape(bsz, seq_len, ATTN_WIDTH)


def setup_inputs(seed: int = 0) -> dict:
    key = jax.random.key(seed)
    ks = jax.random.split(key, 24)
    f32 = jnp.float32
    nrm = lambda k, shape, s: jax.random.normal(k, shape, f32) * s
    n_idx = jnp.arange(SSM_STATE, dtype=f32)
    a_re = -0.5 + nrm(ks[4], (DEPTH, SSM_GROUPS, SSM_STATE), 0.01)
    a_im = math.pi * n_idx + nrm(ks[5], (DEPTH, SSM_GROUPS, SSM_STATE), 0.01)
    log_dt = jax.random.uniform(ks[6], (DEPTH, SSM_GROUPS), f32,
                                math.log(DT_MIN), math.log(DT_MAX))
    return {
        "x": nrm(ks[0], (BATCH, SEQ, D_MODEL), 1.0),
        "c": nrm(ks[1], (BATCH, D_MODEL), 1.0),
        "rel_bias": nrm(ks[2], (REL_BUCKETS, ATTN_HEADS), 0.5),
        "w_ada": nrm(ks[3], (DEPTH, D_MODEL, N_MOD * D_MODEL), 0.5 * D_MODEL ** -0.5),
        "b_ada": nrm(ks[7], (DEPTH, N_MOD * D_MODEL), 0.02),
        "norm_mix_g": 1.0 + nrm(ks[8], (DEPTH, D_MODEL), 0.02),
        "w_in": nrm(ks[9], (DEPTH, D_MODEL, IN_WIDTH), D_MODEL ** -0.5),
        "ssm_a_re": a_re,
        "ssm_a_im": a_im,
        "ssm_log_dt": log_dt,
        "ssm_b_re": nrm(ks[10], (DEPTH, SSM_GROUPS, SSM_STATE, SSM_GROUP), (2 * SSM_GROUP) ** -0.5),
        "ssm_b_im": nrm(ks[11], (DEPTH, SSM_GROUPS, SSM_STATE, SSM_GROUP), (2 * SSM_GROUP) ** -0.5),
        "ssm_c_re": nrm(ks[12], (DEPTH, SSM_GROUPS, SSM_GROUP, SSM_STATE), (2 * SSM_STATE) ** -0.5),
        "ssm_c_im": nrm(ks[13], (DEPTH, SSM_GROUPS, SSM_GROUP, SSM_STATE), (2 * SSM_STATE) ** -0.5),
        "ssm_d": nrm(ks[14], (DEPTH, SSM_WIDTH), 1.0),
        "w_glu": nrm(ks[15], (DEPTH, SSM_WIDTH, SSM_WIDTH), SSM_WIDTH ** -0.5),
        "b_glu": nrm(ks[16], (DEPTH, SSM_WIDTH), 0.02),
        "w_proj_ssm": nrm(ks[17], (DEPTH, SSM_WIDTH, D_MODEL), SSM_WIDTH ** -0.5),
        "w_proj_attn": nrm(ks[18], (DEPTH, ATTN_WIDTH, D_MODEL), ATTN_WIDTH ** -0.5),
        "w_out": nrm(ks[19], (DEPTH, D_MODEL, D_MODEL), D_MODEL ** -0.5),
        "norm_mlp_g": 1.0 + nrm(ks[20], (DEPTH, D_MODEL), 0.02),
        "w_ff1": nrm(ks[21], (DEPTH, D_MODEL, D_FF), D_MODEL ** -0.5),
        "w_ff2": nrm(ks[22], (DEPTH, D_FF, D_MODEL), D_FF ** -0.5),
        "norm_final_g": 1.0 + nrm(ks[23], (D_MODEL,), 0.02),
    }


def reference(x, c, rel_bias, w_ada, b_ada, norm_mix_g, w_in, ssm_a_re, ssm_a_im, ssm_log_dt,
              ssm_b_re, ssm_b_im, ssm_c_re, ssm_c_im, ssm_d, w_glu, b_glu, w_proj_ssm,
              w_proj_attn, w_out, norm_mlp_g, w_ff1, w_ff2, norm_final_g):
    bsz, seq_len, _ = x.shape
    split_at = [SSM_WIDTH, SSM_WIDTH + ATTN_WIDTH, SSM_WIDTH + 2 * ATTN_WIDTH,
                SSM_WIDTH + 3 * ATTN_WIDTH, SSM_WIDTH + 3 * ATTN_WIDTH + D_MODEL]
    c_act = jax.nn.silu(c)
    for l in range(DEPTH):
        mod = c_act @ w_ada[l] + b_ada[l]
        sh1, sc1, g1, sh2, sc2, g2 = [m[:, None, :] for m in jnp.split(mod, N_MOD, axis=-1)]
        h = rms_norm(x, norm_mix_g[l]) * (1.0 + sc1) + sh1
        proj = h @ w_in[l]
        u, q, k, v, ga, gb = jnp.split(proj, split_at, axis=-1)
        y_ssm = s5_branch(u, ssm_a_re[l], ssm_a_im[l], ssm_log_dt[l], ssm_b_re[l], ssm_b_im[l],
                          ssm_c_re[l], ssm_c_im[l], ssm_d[l], w_glu[l], b_glu[l])
        shp = (bsz, seq_len, ATTN_HEADS, HEAD_DIM)
        y_att = moba_attention(q.reshape(shp), k.reshape(shp), v.reshape(shp), rel_bias)
        merged = (jax.nn.sigmoid(ga) * (y_ssm @ w_proj_ssm[l])
                  + jax.nn.sigmoid(gb) * (y_att @ w_proj_attn[l]))
        x = x + g1 * (merged @ w_out[l])
        h2 = rms_norm(x, norm_mlp_g[l]) * (1.0 + sc2) + sh2
        x = x + g2 * (jnp.square(jax.nn.relu(h2 @ w_ff1[l])) @ w_ff2[l])
    return rms_norm(x, norm_final_g)
```

```cpp
#include <hip/hip_runtime.h>
#include <cstdio>
#include <cstdint>

#define LAS __attribute__((address_space(3)))
#define GAS __attribute__((address_space(1)))
typedef unsigned short bf16_t;
typedef short bf16x8 __attribute__((ext_vector_type(8)));
typedef float f32x4 __attribute__((ext_vector_type(4)));
typedef float f32x2 __attribute__((ext_vector_type(2)));
typedef float f32x16 __attribute__((ext_vector_type(16)));
typedef unsigned u32x4 __attribute__((ext_vector_type(4)));
typedef unsigned u32x2 __attribute__((ext_vector_type(2)));
typedef short v4i16_t __attribute__((ext_vector_type(4)));
typedef __bf16 bf16x2_t __attribute__((ext_vector_type(2)));

#ifndef MK_N_LAUNCHES
#define MK_N_LAUNCHES 11
#endif
#ifndef MK_DEBUG
#define MK_DEBUG 0
#endif

constexpr int NB = 8, SEQ = 2048, DM = 2048, M = NB * SEQ;
constexpr int SSMW = 1024, NG = 64, GP = 16, NST = 64;
constexpr int NH = 8, HD = 128, ATW = 1024;
constexpr int DFF = 8192, INW = 8192, NMOD = 6 * DM;
constexpr float EPS = 1e-6f;
constexpr float LOG2E = 1.4426950408889634f;
constexpr float QSCALE = 0.08838834764831845f * LOG2E;
constexpr int TCH = 16;
constexpr int NCH = SEQ / TCH;
constexpr int ASK = 384;
constexpr int N_PHASES = 11;

constexpr size_t MiB = 1u << 20;
constexpr size_t WS_CTL = 0, CTL_ZERO_BYTES = 1 * MiB;
constexpr size_t WS_WIN = 1 * MiB;
constexpr size_t WS_YACT = WS_WIN;
constexpr size_t WS_WGLU = 33 * MiB;
constexpr size_t WS_WPC = 35 * MiB;
constexpr size_t WS_WOUT = 43 * MiB;
constexpr size_t WS_WF1 = 51 * MiB;
constexpr size_t WS_WF2 = 83 * MiB;
constexpr size_t WS_BTE = 115 * MiB;
constexpr size_t WS_BTY = 123 * MiB;
constexpr size_t WS_MODP = 135 * MiB;
constexpr size_t WS_MODF = 141 * MiB;
constexpr size_t WS_KMEAN = 141 * MiB + 512 * 1024;
constexpr size_t WS_A16 = 141 * MiB + 800 * 1024;
constexpr size_t WS_C2 = 142 * MiB;
constexpr size_t WS_SSQ1 = 143 * MiB;
constexpr size_t WS_SSQ2 = 145 * MiB;
constexpr size_t WS_H = 147 * MiB;
constexpr size_t WS_ACAT = WS_H, WS_XS2 = WS_H;
constexpr size_t WS_AS = 211 * MiB;
constexpr size_t WS_Q = 259 * MiB, WS_K = 291 * MiB, WS_V = 323 * MiB;
constexpr size_t WS_SGA = 355 * MiB, WS_SGB = 419 * MiB;
constexpr size_t WS_MERGED = WS_AS;
constexpr size_t WS_FF = WS_AS;
constexpr size_t WS_DBG = 484 * MiB;
constexpr size_t WS_END = 488 * MiB;
static_assert(WS_FF + (size_t)M * DFF * 2 <= WS_SGB + (size_t)M * DM * 2, "ff overlay");

__device__ __forceinline__ unsigned cvtpk(float lo, float hi) { f32x2 v = {lo, hi}; bf16x2_t b = __builtin_convertvector(v, bf16x2_t); return __builtin_bit_cast(unsigned, b); }
__device__ __forceinline__ float bflo(unsigned w) { return __uint_as_float(w << 16); }
__device__ __forceinline__ float bfhi(unsigned w) { return __uint_as_float(w & 0xffff0000u); }
__device__ __forceinline__ float bf2f(bf16_t v) { return __uint_as_float(((unsigned)v) << 16); }
__device__ __forceinline__ float fexp2(float x) { return __builtin_amdgcn_exp2f(x); }
__device__ __forceinline__ float frcp(float x) { return __builtin_amdgcn_rcpf(x); }
__device__ __forceinline__ float sigmoidf_(float x) { return frcp(1.0f + fexp2(-LOG2E * x)); }
__device__ __forceinline__ float wave_sum(float v) {
#pragma unroll
    for (int o = 1; o < 64; o <<= 1) v += __shfl_xor(v, o);
    return v;
}
#define LDS_WAIT() asm volatile("s_waitcnt lgkmcnt(0)" ::: "memory")
#define VM_WAIT() asm volatile("s_waitcnt vmcnt(0)" ::: "memory")

namespace pg8 {
constexpr int BM = 256, BK = 64, HALF = 128, HTB = HALF * BK * 2, STAGE_BYTES = 8 * HTB, NXCD = 8, WGM = 8;
__host__ __device__ __forceinline__ int lds_byte(int r, int c) { const int st = (r >> 4) * 2 + (c >> 5), rr = r & 15, cc = c & 31, ob = rr * 64 + cc * 2; return st * 1024 + (ob ^ (((ob >> 9) & 1) << 5)); }
__host__ __device__ __forceinline__ void stage_rc(int b, int& R, int& C) { const int st = b / 1024, sb = b % 1024, swz = sb ^ (((sb >> 9) & 1) << 5); R = (st >> 1) * 16 + swz / 64; C = (st & 1) * 32 + (swz % 64) / 2; }
__host__ __device__ __forceinline__ int perm32(int rho) { const int n = rho >> 4, i = rho & 15; return 8 * (i >> 2) + 4 * n + (i & 3); }

struct Unit { int pm, pn; };
struct Gemm { const bf16_t* A; const bf16_t* Bt; int lda, ldb, K; };

struct StaticOrder {
    int nM, nN, nwg, G, c;
    __device__ void init(int M_, int N_, int G_, int c_) { nM = M_ / BM; nN = N_ / BM; nwg = nM * nN; G = G_; c = c_; }
    __device__ bool next(int i, Unit& u) const {
        const long L = (long)i * G + c; if (L >= nwg) return false;
        int wgid = (int)L; { const int q = nwg / NXCD, r = nwg % NXCD, xcd = wgid % NXCD, off = wgid / NXCD; wgid = (xcd < r ? xcd * (q + 1) : r * (q + 1) + (xcd - r) * q) + off; }
        const int nig = WGM * nN, gid = wgid / nig, fm = gid * WGM, gsz = (nM - fm) < WGM ? (nM - fm) : WGM;
        u.pm = fm + ((wgid % nig) % gsz); u.pn = (wgid % nig) / gsz; return true;
    }
};
struct GroupOrder {
    int G, c;
    __device__ bool next(int i, Unit& u) const { const int L = i * G + c; if (L >= 256) return false; u.pm = L; u.pn = L >> 2; return true; }
};

template <class Epi, class Sched, bool ALIGN_EPI>
__device__ __forceinline__ void gemm_phase(LAS unsigned char* lds, const Gemm g, const Sched& S, const Epi& E) {
    const int tid = threadIdx.x, wid = __builtin_amdgcn_readfirstlane(tid >> 6), lane = tid & 63, wr = wid >> 2, wc = wid & 3, fr = lane & 15, fq = lane >> 4;
    const int K = g.K, nt = K / BK;
    unsigned voffA[2], voffB[2];
#pragma unroll
    for (int i = 0; i < 2; ++i) { int R, C; stage_rc(tid * 16 + i * 8192, R, C); const int Rb = Epi::PERM ? ((R & ~31) + perm32(R & 31)) : R;
        voffA[i] = (unsigned)(R * g.lda + C) * 2u; voffB[i] = (unsigned)(Rb * g.ldb + C) * 2u; }
    const size_t kstep = (size_t)(BK * 2);
    const size_t hsA = (size_t)HALF * g.lda * 2, hsB = (size_t)HALF * g.ldb * 2;
    const size_t tsA = 2 * hsA, tsB = 2 * hsB;
    const unsigned ldsw = (unsigned)wid * 1024u;
    const int aoff = lds_byte(wr * 64 + fr, fq * 8), boff = lds_byte(wc * 32 + fr, fq * 8);
#define PG8_SA(b, h) (((b) * 2 + (h)) * HTB)
#define PG8_SB(b, h) ((4 + (b) * 2 + (h)) * HTB)
#define PG8_STAGE(bufoff, gbase, voff) do { _Pragma("unroll") for (int _i = 0; _i < 2; ++_i) \
        __builtin_amdgcn_global_load_lds((const unsigned*)((const char*)(gbase) + (voff)[_i]), (LAS unsigned*)(lds + (bufoff) + ldsw + _i * 8192), 16, 0, 0); } while (0)
#define PG8_LDA(dst, b, h) do { _Pragma("unroll") for (int m = 0; m < 4; ++m) _Pragma("unroll") for (int k = 0; k < 2; ++k) dst[m][k] = *(const LAS bf16x8*)(lds + PG8_SA(b, h) + aoff + m * 2048 + k * 1024); } while (0)
#define PG8_LDB(dst, b, h) do { _Pragma("unroll") for (int n = 0; n < 2; ++n) _Pragma("unroll") for (int k = 0; k < 2; ++k) dst[n][k] = *(const LAS bf16x8*)(lds + PG8_SB(b, h) + boff + n * 2048 + k * 1024); } while (0)
#define PG8_MMA(ai, bj, At, Bt) do { __builtin_amdgcn_s_setprio(1); _Pragma("unroll") for (int m = 0; m < 4; ++m) _Pragma("unroll") for (int n = 0; n < 2; ++n) _Pragma("unroll") for (int k = 0; k < 2; ++k) \
        acc[ai][bj][m][n] = __builtin_amdgcn_mfma_f32_16x16x32_bf16(Bt[n][k], At[m][k], acc[ai][bj][m][n], 0, 0, 0); __builtin_amdgcn_s_setprio(0); } while (0)
#define PG8_WAIT_V(n) asm volatile("s_waitcnt vmcnt(" #n ")" ::: "memory")
#define PG8_WAIT_L(n) asm volatile("s_waitcnt lgkmcnt(" #n ")" ::: "memory")
#define PG8_BAR __builtin_amdgcn_s_barrier()
#define PG8_SCHED __builtin_amdgcn_sched_barrier(0)
    Unit cur, nxt; int ui = 0;
    if (!S.next(0, cur)) return;
    f32x4 acc[2][2][4][2];
#pragma unroll
    for (int a = 0; a < 2; ++a)
#pragma unroll
        for (int b = 0; b < 2; ++b)
#pragma unroll
            for (int m = 0; m < 4; ++m)
#pragma unroll
                for (int n = 0; n < 2; ++n) acc[a][b][m][n] = (f32x4){0.f, 0.f, 0.f, 0.f};
    bf16x8 At[4][2], B0[2][2], B1[2][2];
    const char* cA = (const char*)g.A + (size_t)cur.pm * tsA; const char* cB = (const char*)g.Bt + (size_t)cur.pn * tsB;
    PG8_STAGE(PG8_SB(0, 0), cB, voffB); PG8_STAGE(PG8_SB(0, 1), cB + hsB, voffB); PG8_STAGE(PG8_SA(0, 0), cA, voffA); PG8_STAGE(PG8_SA(0, 1), cA + hsA, voffA);
    if (wr == 1) PG8_BAR;
    PG8_WAIT_V(2); PG8_BAR;
    PG8_STAGE(PG8_SB(1, 0), cB + kstep, voffB); PG8_STAGE(PG8_SA(1, 0), cA + kstep, voffA); PG8_STAGE(PG8_SB(1, 1), cB + hsB + kstep, voffB);
    PG8_WAIT_V(6); PG8_BAR;
    for (;;) {
        const bool has_next = S.next(ui + 1, nxt);
        const char* nA = has_next ? (const char*)g.A + (size_t)nxt.pm * tsA : cA; const char* nB = has_next ? (const char*)g.Bt + (size_t)nxt.pn * tsB : cB;
#pragma unroll 1
        for (int t = 0; t < nt; t += 2) {
            const bool last = (t == nt - 2);
            const char* a1 = cA + (size_t)(t + 1) * kstep;
            const char* a2 = last ? nA : cA + (size_t)(t + 2) * kstep; const char* b2 = last ? nB : cB + (size_t)(t + 2) * kstep;
            const char* a3 = a2 + kstep; const char* b3 = b2 + kstep;
            if constexpr (Epi::MIDHOOK) { if (t == (nt >> 1)) E.mid(acc, cur, wr, wc, fr, fq); }
            PG8_LDB(B0, 0, 0); PG8_LDB(B1, 0, 1); PG8_SCHED; PG8_LDA(At, 0, 0); PG8_STAGE(PG8_SA(1, 1), a1 + hsA, voffA);
            PG8_WAIT_V(8); PG8_WAIT_L(0); PG8_BAR; PG8_MMA(0, 0, At, B0); PG8_MMA(0, 1, At, B1); PG8_BAR; PG8_SCHED;
            PG8_LDA(At, 0, 1); PG8_STAGE(PG8_SB(0, 0), b2, voffB); PG8_STAGE(PG8_SB(0, 1), b2 + hsB, voffB); PG8_STAGE(PG8_SA(0, 0), a2, voffA);
            PG8_WAIT_V(8); PG8_WAIT_L(0); PG8_BAR; PG8_MMA(1, 0, At, B0); PG8_MMA(1, 1, At, B1); PG8_BAR; PG8_SCHED;
            PG8_LDB(B0, 1, 0); PG8_LDB(B1, 1, 1); PG8_SCHED; PG8_LDA(At, 1, 0); PG8_STAGE(PG8_SA(0, 1), a2 + hsA, voffA);
            PG8_WAIT_V(8); PG8_WAIT_L(0); PG8_BAR; PG8_MMA(0, 0, At, B0); PG8_MMA(0, 1, At, B1); PG8_BAR; PG8_SCHED;
            PG8_LDA(At, 1, 1); PG8_STAGE(PG8_SB(1, 0), b3, voffB); PG8_STAGE(PG8_SB(1, 1), b3 + hsB, voffB); PG8_STAGE(PG8_SA(1, 0), a3, voffA);
            PG8_WAIT_V(8); PG8_WAIT_L(0); PG8_BAR; PG8_MMA(1, 0, At, B0); PG8_MMA(1, 1, At, B1); PG8_BAR; PG8_SCHED;
        }
        if constexpr (ALIGN_EPI) { if (wr == 0) PG8_BAR; }
        if constexpr (!Epi::AFTER_DRAIN) { E(acc, cur, wr, wc, fr, fq); }
        if (!has_next) break;
#pragma unroll
        for (int a = 0; a < 2; ++a)
#pragma unroll
            for (int b = 0; b < 2; ++b)
#pragma unroll
                for (int m = 0; m < 4; ++m)
#pragma unroll
                    for (int n = 0; n < 2; ++n) acc[a][b][m][n] = (f32x4){0.f, 0.f, 0.f, 0.f};
        cur = nxt; cA = nA; cB = nB; ++ui;
        if constexpr (ALIGN_EPI) { if (wr == 1) PG8_BAR; }
    }
    PG8_WAIT_V(0);
    if constexpr (!ALIGN_EPI) { if (wr == 0) PG8_BAR; }
    PG8_BAR;
    if constexpr (Epi::AFTER_DRAIN) { E.fused(acc, cur, wr, wc, fr, fq, lds, wid, lane); }
#undef PG8_SA
#undef PG8_SB
#undef PG8_STAGE
#undef PG8_LDA
#undef PG8_LDB
#undef PG8_MMA
#undef PG8_WAIT_V
#undef PG8_WAIT_L
#undef PG8_BAR
#undef PG8_SCHED
}
}
using pg8::Unit;
typedef f32x4 AccT[2][2][4][2];

struct EpiProj {
    static constexpr bool PERM = true, AFTER_DRAIN = false, MIDHOOK = false;
    bf16_t *As, *Q, *Kk, *V, *SGA, *SGB;
    __device__ __forceinline__ void operator()(const AccT& acc, const Unit& u, int wr, int wc, int fr, int fq) const {
        asm volatile("" : "+v"(fr), "+v"(fq));
        const int seg = u.pn >> 2;
        const int row0 = u.pm * 256 + wr * 64 + fr;
        const int cseg = (u.pn & 3) * 256 + wc * 32 + 8 * fq;
#pragma unroll
        for (int ai = 0; ai < 2; ++ai)
#pragma unroll
            for (int m = 0; m < 4; ++m) {
                const int r = row0 + ai * 128 + m * 16;
#pragma unroll
                for (int bj = 0; bj < 2; ++bj) {
                    f32x4 v0 = acc[ai][bj][m][0], v1 = acc[ai][bj][m][1];
                    const int c = cseg + bj * 128;
                    bf16_t* dst;
                    if (seg == 0) {
                        const int gg = c >> 4, p0 = c & 15, b = r >> 11, l = r & 2047;
                        dst = As + ((size_t)(gg * 1024 + b * 128 + (l >> 4)) * ASK + (l & 15) * 16 + p0);
                    } else if (seg == 1) { v0 = v0 * QSCALE; v1 = v1 * QSCALE; dst = Q + (size_t)r * 1024 + c; }
                    else if (seg == 2) { dst = Kk + (size_t)r * 1024 + c; }
                    else if (seg == 3) { dst = V + (size_t)r * 1024 + c; }
                    else {
#pragma unroll
                        for (int j = 0; j < 4; ++j) { v0[j] = sigmoidf_(v0[j]); v1[j] = sigmoidf_(v1[j]); }
                        const int c2 = ((u.pn & 7) * 256) + wc * 32 + 8 * fq + bj * 128;
                        if (seg >= 6) {
#pragma unroll
                            for (int j = 0; j < 4; ++j) { v0[j] = fmaxf(v0[j], 1e-12f); v1[j] = fmaxf(v1[j], 1e-12f); }
                            dst = SGB + (size_t)r * 2048 + c2;
                        } else dst = SGA + (size_t)r * 2048 + c2;
                    }
                    u32x4 w; w.x = cvtpk(v0[0], v0[1]); w.y = cvtpk(v0[2], v0[3]); w.z = cvtpk(v1[0], v1[1]); w.w = cvtpk(v1[2], v1[3]);
                    *(u32x4*)dst = w;
                }
            }
    }
};

struct EpiScan {
    static constexpr bool PERM = false, AFTER_DRAIN = true, MIDHOOK = false;
    bf16_t* As; const float* A16;
    __device__ __forceinline__ void fused(AccT& acc, const Unit& u, int wr, int wc, int fr, int fq, LAS unsigned char* lds, int wid, int lane) const {
        LAS float* EL = (LAS float*)lds;
#pragma unroll
        for (int ai = 0; ai < 2; ++ai)
#pragma unroll
            for (int m = 0; m < 4; ++m) { const int r = ai * 128 + wr * 64 + m * 16 + fr;
#pragma unroll
                for (int n = 0; n < 2; ++n) *(LAS f32x4*)(EL + r * 128 + wc * 32 + n * 16 + 4 * fq) = acc[ai][0][m][n]; }
        LDS_WAIT(); __builtin_amdgcn_s_barrier(); asm volatile("" ::: "memory");
        const int tid = wid * 64 + lane;
        if (tid < 128) {
            const int bl = tid >> 6, n = tid & 63, g = u.pn;
            const float are = A16[(g * 64 + n) * 2], aim = A16[(g * 64 + n) * 2 + 1];
            float sre = 0.f, sim = 0.f;
            bf16_t* dst = As + ((size_t)(u.pm * 256 + bl * 128) * ASK + 256 + n);
            const LAS float* e = EL + (bl * 128) * 128 + n;
            for (int c = 0; c < NCH; ++c) {
                dst[(size_t)c * ASK] = (bf16_t)(cvtpk(sre, 0.f) & 0xffffu); dst[(size_t)c * ASK + 64] = (bf16_t)(cvtpk(sim, 0.f) & 0xffffu);
                const float ere = e[c * 128], eim = e[c * 128 + 64];
                const float nre = are * sre - aim * sim + ere, nim = are * sim + aim * sre + eim;
                sre = nre; sim = nim;
            }
        }
    }
};

struct EpiSsmOut {
    static constexpr bool PERM = true, AFTER_DRAIN = false, MIDHOOK = false;
    const bf16_t* As; const float* dsk; bf16_t* Yact;
    __device__ __forceinline__ void operator()(const AccT& acc, const Unit& u, int wr, int wc, int fr, int fq) const {
        asm volatile("" : "+v"(fr), "+v"(fq));
        const int g = u.pn, mt = u.pm & 3;
#pragma unroll
        for (int bj = 0; bj < 2; ++bj) {
            const int col = bj * 128 + wc * 32 + 8 * fq, t = col >> 4, p0 = col & 15;
            const f32x4 d0 = *(const f32x4*)(dsk + g * 16 + p0), d1 = *(const f32x4*)(dsk + g * 16 + p0 + 4);
#pragma unroll
            for (int ai = 0; ai < 2; ++ai)
#pragma unroll
                for (int m = 0; m < 4; ++m) {
                    const int rl = ai * 128 + wr * 64 + m * 16 + fr, R = mt * 256 + rl;
                    const u32x4 uw = *(const u32x4*)(As + ((size_t)(g * 1024 + R) * ASK + col));
                    f32x4 v0 = acc[ai][bj][m][0], v1 = acc[ai][bj][m][1];
                    v0[0] += d0[0] * bflo(uw.x); v0[1] += d0[1] * bfhi(uw.x); v0[2] += d0[2] * bflo(uw.y); v0[3] += d0[3] * bfhi(uw.y);
                    v1[0] += d1[0] * bflo(uw.z); v1[1] += d1[1] * bfhi(uw.z); v1[2] += d1[2] * bflo(uw.w); v1[3] += d1[3] * bfhi(uw.w);
#pragma unroll
                    for (int j = 0; j < 4; ++j) {
                        { const float y = v0[j], z = 0.7978845608028654f * (y + 0.044715f * y * y * y); v0[j] = y * frcp(1.0f + fexp2(-2.0f * LOG2E * z)); }
                        { const float y = v1[j], z = 0.7978845608028654f * (y + 0.044715f * y * y * y); v1[j] = y * frcp(1.0f + fexp2(-2.0f * LOG2E * z)); }
                    }
                    u32x4 w; w.x = cvtpk(v0[0], v0[1]); w.y = cvtpk(v0[2], v0[3]); w.z = cvtpk(v1[0], v1[1]); w.w = cvtpk(v1[2], v1[3]);
                    *(u32x4*)(Yact + ((size_t)(R * 16 + t) * 1024 + g * 16 + p0)) = w;
                    if (m & 1) asm volatile("" ::: "memory");
                }
        }
    }
};

struct EpiGlu {
    static constexpr bool PERM = true, AFTER_DRAIN = false, MIDHOOK = false;
    const bf16_t* Yact; const float* bglu; bf16_t* Acat;
    __device__ __forceinline__ void operator()(const AccT& acc, const Unit& u, int wr, int wc, int fr, int fq) const {
        asm volatile("" : "+v"(fr), "+v"(fq));
        const int row0 = u.pm * 256 + wr * 64 + fr;
#pragma unroll
        for (int bj = 0; bj < 2; ++bj) {
            const int c = u.pn * 256 + bj * 128 + wc * 32 + 8 * fq;
            const f32x4 b0 = *(const f32x4*)(bglu + c), b1 = *(const f32x4*)(bglu + c + 4);
#pragma unroll
            for (int ai = 0; ai < 2; ++ai)
#pragma unroll
                for (int m = 0; m < 4; ++m) {
                    const int r = row0 + ai * 128 + m * 16;
                    const u32x4 yw = *(const u32x4*)(Yact + (size_t)r * 1024 + c);
                    const f32x4 z0 = acc[ai][bj][m][0] + b0, z1 = acc[ai][bj][m][1] + b1;
                    u32x4 w;
                    w.x = cvtpk(bflo(yw.x) * sigmoidf_(z0[0]), bfhi(yw.x) * sigmoidf_(z0[1]));
                    w.y = cvtpk(bflo(yw.y) * sigmoidf_(z0[2]), bfhi(yw.y) * sigmoidf_(z0[3]));
                    w.z = cvtpk(bflo(yw.z) * sigmoidf_(z1[0]), bfhi(yw.z) * sigmoidf_(z1[1]));
                    w.w = cvtpk(bflo(yw.w) * sigmoidf_(z1[2]), bfhi(yw.w) * sigmoidf_(z1[3]));
                    *(u32x4*)(Acat + (size_t)r * 2048 + c) = w;
                }
        }
    }
};

struct EpiMerge {
    static constexpr bool PERM = true, AFTER_DRAIN = false, MIDHOOK = true;
    const bf16_t *SGA, *SGB; bf16_t* Mg;
    __device__ __forceinline__ void mid(AccT& acc, const Unit& u, int wr, int wc, int fr, int fq) const {
        asm volatile("" : "+v"(fr), "+v"(fq));
        const int row0 = u.pm * 256 + wr * 64 + fr;
#pragma unroll
        for (int ai = 0; ai < 2; ++ai)
#pragma unroll
            for (int m = 0; m < 4; ++m)
#pragma unroll
                for (int bj = 0; bj < 2; ++bj) {
                    const size_t off = (size_t)(row0 + ai * 128 + m * 16) * 2048 + u.pn * 256 + bj * 128 + wc * 32 + 8 * fq;
                    const u32x4 a = *(const u32x4*)(SGA + off), b = *(const u32x4*)(SGB + off);
                    f32x4& v0 = acc[ai][bj][m][0]; f32x4& v1 = acc[ai][bj][m][1];
                    v0[0] *= bflo(a.x) * frcp(bflo(b.x)); v0[1] *= bfhi(a.x) * frcp(bfhi(b.x)); v0[2] *= bflo(a.y) * frcp(bflo(b.y)); v0[3] *= bfhi(a.y) * frcp(bfhi(b.y));
                    v1[0] *= bflo(a.z) * frcp(bflo(b.z)); v1[1] *= bfhi(a.z) * frcp(bfhi(b.z)); v1[2] *= bflo(a.w) * frcp(bflo(b.w)); v1[3] *= bfhi(a.w) * frcp(bfhi(b.w));
                    if (bj) asm volatile("" ::: "memory");
                }
    }
    __device__ __forceinline__ void operator()(const AccT& acc, const Unit& u, int wr, int wc, int fr, int fq) const {
        asm volatile("" : "+v"(fr), "+v"(fq));
        const int row0 = u.pm * 256 + wr * 64 + fr;
#pragma unroll
        for (int ai = 0; ai < 2; ++ai)
#pragma unroll
            for (int m = 0; m < 4; ++m)
#pragma unroll
                for (int bj = 0; bj < 2; ++bj) {
                    const size_t off = (size_t)(row0 + ai * 128 + m * 16) * 2048 + u.pn * 256 + bj * 128 + wc * 32 + 8 * fq;
                    const u32x4 b = *(const u32x4*)(SGB + off);
                    const f32x4 v0 = acc[ai][bj][m][0], v1 = acc[ai][bj][m][1];
                    u32x4 w;
                    w.x = cvtpk(v0[0] * bflo(b.x), v0[1] * bfhi(b.x)); w.y = cvtpk(v0[2] * bflo(b.y), v0[3] * bfhi(b.y));
                    w.z = cvtpk(v1[0] * bflo(b.z), v1[1] * bfhi(b.z)); w.w = cvtpk(v1[2] * bflo(b.w), v1[3] * bfhi(b.w));
                    *(u32x4*)(Mg + off) = w;
                    if (bj) asm volatile("" ::: "memory");
                }
    }
};

struct EpiRes1 {
    static constexpr bool PERM = true, AFTER_DRAIN = false, MIDHOOK = false;
    const float* X; const float* modf; const float* gmlp; float* Out; bf16_t* Xs2; float* ssq;
    __device__ __forceinline__ void operator()(const AccT& acc, const Unit& u, int wr, int wc, int fr, int fq) const {
        asm volatile("" : "+v"(fr), "+v"(fq));
        const int row0 = u.pm * 256 + wr * 64 + fr, b = u.pm >> 3;
        const float* mb = modf + (size_t)b * NMOD;
        float sq[2][4];
#pragma unroll
        for (int ai = 0; ai < 2; ++ai)
#pragma unroll
            for (int m = 0; m < 4; ++m) sq[ai][m] = 0.f;
#pragma unroll
        for (int bj = 0; bj < 2; ++bj) {
            const int c = u.pn * 256 + bj * 128 + wc * 32 + 8 * fq;
            const f32x4 g10 = *(const f32x4*)(mb + 2 * DM + c), g11 = *(const f32x4*)(mb + 2 * DM + c + 4);
            const f32x4 s0 = *(const f32x4*)(mb + 4 * DM + c), s1 = *(const f32x4*)(mb + 4 * DM + c + 4);
            const f32x4 gm0 = *(const f32x4*)(gmlp + c), gm1 = *(const f32x4*)(gmlp + c + 4);
            const f32x4 gg0 = gm0 * (s0 + 1.0f), gg1 = gm1 * (s1 + 1.0f);
#pragma unroll
            for (int ai = 0; ai < 2; ++ai)
#pragma unroll
                for (int m = 0; m < 4; ++m) {
                    const size_t off = (size_t)(row0 + ai * 128 + m * 16) * DM + c;
                    const f32x4 x0 = *(const f32x4*)(X + off), x1 = *(const f32x4*)(X + off + 4);
                    const f32x4 y0 = x0 + g10 * acc[ai][bj][m][0], y1 = x1 + g11 * acc[ai][bj][m][1];
                    *(f32x4*)(Out + off) = y0; *(f32x4*)(Out + off + 4) = y1;
                    sq[ai][m] += (y0[0] * y0[0] + y0[1] * y0[1]) + (y0[2] * y0[2] + y0[3] * y0[3]) + (y1[0] * y1[0] + y1[1] * y1[1]) + (y1[2] * y1[2] + y1[3] * y1[3]);
                    const f32x4 h0 = y0 * gg0, h1 = y1 * gg1;
                    u32x4 w; w.x = cvtpk(h0[0], h0[1]); w.y = cvtpk(h0[2], h0[3]); w.z = cvtpk(h1[0], h1[1]); w.w = cvtpk(h1[2], h1[3]);
                    *(u32x4*)(Xs2 + off) = w;
                }
        }
#pragma unroll
        for (int ai = 0; ai < 2; ++ai)
#pragma unroll
            for (int m = 0; m < 4; ++m) {
                float s = sq[ai][m]; s += __shfl_xor(s, 16); s += __shfl_xor(s, 32);
                if (fq == 0) ssq[(size_t)(row0 + ai * 128 + m * 16) * 32 + u.pn * 4 + wc] = s;
            }
    }
};

struct EpiFF1 {
    static constexpr bool PERM = true, AFTER_DRAIN = false, MIDHOOK = false;
    const float* ssq; const float* c2; bf16_t* FF;
    __device__ __forceinline__ void operator()(const AccT& acc, const Unit& u, int wr, int wc, int fr, int fq) const {
        asm volatile("" : "+v"(fr), "+v"(fq));
        const int row0 = u.pm * 256 + wr * 64 + fr, b = u.pm >> 3;
        float rs[2][4];
#pragma unroll
        for (int ai = 0; ai < 2; ++ai)
#pragma unroll
            for (int m = 0; m < 4; ++m) {
                const float* p = ssq + (size_t)(row0 + ai * 128 + m * 16) * 32 + fq * 8;
                const f32x4 a = *(const f32x4*)p, bb = *(const f32x4*)(p + 4);
                float s = (a[0] + a[1]) + (a[2] + a[3]) + (bb[0] + bb[1]) + (bb[2] + bb[3]);
                s += __shfl_xor(s, 16); s += __shfl_xor(s, 32);
                rs[ai][m] = 1.0f / sqrtf(s * (1.0f / DM) + EPS);
            }
#pragma unroll
        for (int bj = 0; bj < 2; ++bj) {
            const int c = u.pn * 256 + bj * 128 + wc * 32 + 8 * fq;
            const f32x4 k0 = *(const f32x4*)(c2 + (size_t)b * DFF + c), k1 = *(const f32x4*)(c2 + (size_t)b * DFF + c + 4);
#pragma unroll
            for (int ai = 0; ai < 2; ++ai)
#pragma unroll
                for (int m = 0; m < 4; ++m) {
                    f32x4 v0 = acc[ai][bj][m][0] * rs[ai][m] + k0, v1 = acc[ai][bj][m][1] * rs[ai][m] + k1;
#pragma unroll
                    for (int j = 0; j < 4; ++j) { const float a = fmaxf(v0[j], 0.f), bq = fmaxf(v1[j], 0.f); v0[j] = a * a; v1[j] = bq * bq; }
                    u32x4 w; w.x = cvtpk(v0[0], v0[1]); w.y = cvtpk(v0[2], v0[3]); w.z = cvtpk(v1[0], v1[1]); w.w = cvtpk(v1[2], v1[3]);
                    *(u32x4*)(FF + (size_t)(row0 + ai * 128 + m * 16) * DFF + c) = w;
                }
        }
    }
};

struct EpiRes2 {
    static constexpr bool PERM = false, AFTER_DRAIN = false, MIDHOOK = false;
    const float* modf; float* Out; float* ssq;
    __device__ __forceinline__ void operator()(const AccT& acc, const Unit& u, int wr, int wc, int fr, int fq) const {
        asm volatile("" : "+v"(fr), "+v"(fq));
        const int row0 = u.pm * 256 + wr * 64 + fr, b = u.pm >> 3;
        const float* g2 = modf + (size_t)b * NMOD + 5 * DM;
        float sq[2][4];
#pragma unroll
        for (int ai = 0; ai < 2; ++ai)
#pragma unroll
            for (int m = 0; m < 4; ++m) sq[ai][m] = 0.f;
#pragma unroll
        for (int bj = 0; bj < 2; ++bj)
#pragma unroll
            for (int n = 0; n < 2; ++n) {
                const int c = u.pn * 256 + bj * 128 + wc * 32 + n * 16 + 4 * fq;
                const f32x4 gv = *(const f32x4*)(g2 + c);
#pragma unroll
                for (int ai = 0; ai < 2; ++ai)
#pragma unroll
                    for (int m = 0; m < 4; ++m) {
                        const size_t off = (size_t)(row0 + ai * 128 + m * 16) * DM + c;
                        const f32x4 y = *(const f32x4*)(Out + off) + gv * acc[ai][bj][m][n];
                        *(f32x4*)(Out + off) = y;
                        sq[ai][m] += (y[0] * y[0] + y[1] * y[1]) + (y[2] * y[2] + y[3] * y[3]);
                    }
            }
#pragma unroll
        for (int ai = 0; ai < 2; ++ai)
#pragma unroll
            for (int m = 0; m < 4; ++m) {
                float s = sq[ai][m]; s += __shfl_xor(s, 16); s += __shfl_xor(s, 32);
                if (fq == 0) ssq[(size_t)(row0 + ai * 128 + m * 16) * 32 + u.pn * 4 + wc] = s;
            }
    }
};

constexpr int NWAVES = 8;
constexpr int RING_BYTES = 131072;
constexpr int LDSCTL_OFF = RING_BYTES, MISC_OFF = LDSCTL_OFF + 320;
constexpr int LDS_BYTES = 147456;
typedef GAS unsigned gu32;
#define RLX_AGENT __ATOMIC_RELAXED, __HIP_MEMORY_SCOPE_AGENT
constexpr int CW_BAR = 4096;

#define XB_TMO      128
#define XB_XCNT(j)  (256  + 64 * (j))
#define XB_XSUB(j)  (1280 + 64 * (j))
#define XB_XGEN(j)  (2304 + 64 * (j))
#define XB_TOP      3328
#define XB_TOPGEN   3392
#define XCD_BAR_WORDS 3456
#define XB_SPIN_CAP (1u << 22)
__device__ __forceinline__ unsigned xb_ld(unsigned* p)              { return __hip_atomic_load(p, __ATOMIC_RELAXED, __HIP_MEMORY_SCOPE_AGENT); }
__device__ __forceinline__ unsigned xb_add(unsigned* p, unsigned v) { return __hip_atomic_fetch_add(p, v, __ATOMIC_RELAXED, __HIP_MEMORY_SCOPE_AGENT); }
__device__ __forceinline__ unsigned xb_xcc_id() { return (unsigned)__builtin_amdgcn_s_getreg((3 << 11) | 20) & 0xFu; }
#define XB_SPIN(cond, bar) do { unsigned _sp = 0; while (cond) { __builtin_amdgcn_s_sleep(1); \
    if ((++_sp & 255u) == 0u) { if (xb_ld(&(bar)[XB_TMO])) break; if (_sp > XB_SPIN_CAP) { atomicAdd(&(bar)[XB_TMO], 1u); break; } } } } while (0)
struct XcdBarrier { unsigned* bar; unsigned x; volatile LAS unsigned* st; };
__device__ __forceinline__ XcdBarrier xcd_barrier_post(unsigned* bar, volatile LAS unsigned* st) {
    XcdBarrier b; b.bar = bar; b.x = xb_xcc_id(); b.st = st;
    if (threadIdx.x == 0) (void)xb_add(&bar[XB_XCNT(b.x)], 1u);
    return b;
}
__device__ __forceinline__ void xcd_barrier_complete(unsigned* bar, unsigned x, unsigned& nloc, unsigned& nx) {
    const unsigned G = gridDim.x * gridDim.y * gridDim.z;
    unsigned sum, cnt, mine, sp = 0u;
    for (;;) {
        sum = 0u; cnt = 0u; mine = 0u;
#pragma unroll
        for (unsigned j = 0; j < 16; ++j) { const unsigned c = xb_ld(&bar[XB_XCNT(j)]); sum += c; cnt += (c > 0u) ? 1u : 0u; mine = (j == x) ? c : mine; }
        if (sum == G) break;
        __builtin_amdgcn_s_sleep(1);
        if ((++sp & 255u) == 0u) { if (xb_ld(&bar[XB_TMO])) break; if (sp > XB_SPIN_CAP) { atomicAdd(&bar[XB_TMO], 1u); break; } }
    }
    nloc = mine > 0u ? mine : 1u; nx = cnt > 0u ? cnt : 1u;
}
__device__ __forceinline__ void xcd_barrier(const XcdBarrier& b) {
    asm volatile("s_waitcnt vmcnt(0)" ::: "memory");
    __syncthreads();
    if (threadIdx.x == 0) {
        unsigned* bar = b.bar;
        __builtin_amdgcn_s_waitcnt(0);
        unsigned nloc = b.st[0], nx = b.st[1];
        if (nloc == 0u) { xcd_barrier_complete(bar, b.x, nloc, nx); b.st[0] = nloc; b.st[1] = nx; }
        const unsigned old = xb_add(&bar[XB_XSUB(b.x)], 1u);
        const unsigned gen = old / nloc;
        if (old + 1u == (gen + 1u) * nloc) {
            __builtin_amdgcn_fence(__ATOMIC_RELEASE, "agent");
            asm volatile("s_waitcnt vmcnt(0)" ::: "memory");
            const unsigned og = xb_add(&bar[XB_TOP], 1u);
            const unsigned tg = og / nx;
            if (og + 1u == (tg + 1u) * nx) xb_add(&bar[XB_TOPGEN], 1u);
            else XB_SPIN(xb_ld(&bar[XB_TOPGEN]) == tg, bar);
            __builtin_amdgcn_fence(__ATOMIC_ACQUIRE, "agent");
            xb_add(&bar[XB_XGEN(b.x)], 1u);
            asm volatile("s_waitcnt vmcnt(0)" ::: "memory");
        } else {
            XB_SPIN(xb_ld(&bar[XB_XGEN(b.x)]) == gen, bar);
            __builtin_amdgcn_fence(__ATOMIC_ACQUIRE, "agent");
            asm volatile("s_waitcnt vmcnt(0)" ::: "memory");
        }
    }
    __syncthreads();
}

struct Args { const float* in[24]; float* out; unsigned char* ws; int ph_lo, ph_hi; };

struct Frame {
    LAS unsigned char* lds;
    int tid, lane, wave, vcu, G;
};

__device__ __forceinline__ unsigned f2bf(float f) { unsigned u = __builtin_bit_cast(unsigned, f); return (u + 0x7fffu + ((u >> 16) & 1u)) >> 16; }
__device__ __forceinline__ unsigned pk2(float lo, float hi) { return f2bf(lo) | (f2bf(hi) << 16); }
__device__ __forceinline__ void p0_transpose_item(const float* W, int N, bf16_t* WT, int ldt, int koff, LAS float* scr, int item, int lane) {
    const int nblk = N / 32, kb = item / nblk, nb = item % nblk, k0 = 64 * kb, n0 = 32 * nb;
#pragma unroll 8
    for (int i = 0; i < 32; ++i) { const int kk = 2 * i + (lane >> 5); scr[kk * 33 + (lane & 31)] = W[(size_t)(k0 + kk) * N + n0 + (lane & 31)]; }
    LDS_WAIT(); asm volatile("" ::: "memory");
    const int c = lane & 7;
#pragma unroll
    for (int j = 0; j < 4; ++j) { const int n = (lane >> 3) + 8 * j; const LAS float* s = scr + (8 * c) * 33 + n;
        u32x4 o; o.x = pk2(s[0 * 33], s[1 * 33]); o.y = pk2(s[2 * 33], s[3 * 33]); o.z = pk2(s[4 * 33], s[5 * 33]); o.w = pk2(s[6 * 33], s[7 * 33]);
        *(u32x4*)(WT + (size_t)(n0 + n) * ldt + koff + k0 + 8 * c) = o; }
    LDS_WAIT(); asm volatile("" ::: "memory");
}
__device__ __forceinline__ void p0_mod_item(const float* cvec, const float* wada, float* modp, LAS float* scr, int mi, int lane) {
    const int jt = mi % 48, ks = mi / 48;
#pragma unroll
    for (int i = 0; i < 16; ++i) { const int idx = i * 64 + lane, b = idx >> 7, kk = idx & 127; const float v = cvec[b * DM + ks * 128 + kk]; scr[idx] = v * sigmoidf_(v); }
    LDS_WAIT(); asm volatile("" ::: "memory");
    f32x4 acc[8];
#pragma unroll
    for (int b = 0; b < 8; ++b) acc[b] = (f32x4){0.f, 0.f, 0.f, 0.f};
    const float* wp = wada + (size_t)(ks * 128) * NMOD + jt * 256 + lane * 4;
#pragma unroll 8
    for (int kk = 0; kk < 128; ++kk) {
        const f32x4 w = *(const f32x4*)(wp + (size_t)kk * NMOD);
#pragma unroll
        for (int b = 0; b < 8; ++b) acc[b] += w * scr[b * 128 + kk];
    }
#pragma unroll
    for (int b = 0; b < 8; ++b) *(f32x4*)(modp + ((size_t)(ks * 8 + b)) * NMOD + jt * 256 + lane * 4) = acc[b];
    LDS_WAIT(); asm volatile("" ::: "memory");
}
__device__ __forceinline__ void p0_ssm_tables(const Frame& F, const Args& a, int g) {
    unsigned char* ws = a.ws;
    LAS float* pwr = (LAS float*)F.lds;
    LAS float* pwi = pwr + 64 * 17;
    LAS float* bbr = pwi + 64 * 17;
    LAS float* bbi = bbr + 1024;
    LAS float* cre = bbi + 1024;
    LAS float* cim = cre + 1024;
    LAS float* klag = cim + 1024;
    const int tid = F.tid;
    if (tid < 64) {
        const int n = tid;
        const double dt = exp((double)a.in[9][g]);
        const double are = (double)a.in[7][g * 64 + n], aim = (double)a.in[8][g * 64 + n];
        const double mag = exp(dt * are), th = dt * aim;
        const double abr = mag * cos(th), abi = mag * sin(th);
        const double den = are * are + aim * aim, pre = abr - 1.0;
        const double fre = (pre * are + abi * aim) / den, fim = (abi * are - pre * aim) / den;
        double pr = 1.0, pi = 0.0;
        for (int k = 0; k <= 16; ++k) { pwr[n * 17 + k] = (float)pr; pwi[n * 17 + k] = (float)pi; const double npr = pr * abr - pi * abi, npi = pr * abi + pi * abr; pr = npr; pi = npi; }
        float* A16 = (float*)(ws + WS_A16);
        A16[(g * 64 + n) * 2] = pwr[n * 17 + 16]; A16[(g * 64 + n) * 2 + 1] = pwi[n * 17 + 16];
        for (int p = 0; p < 16; ++p) { const double br = (double)a.in[10][(g * 64 + n) * 16 + p], bi = (double)a.in[11][(g * 64 + n) * 16 + p];
            bbr[n * 16 + p] = (float)(fre * br - fim * bi); bbi[n * 16 + p] = (float)(fre * bi + fim * br); }
    }
    for (int i = tid; i < 1024; i += 512) { cre[i] = a.in[12][g * 1024 + i]; cim[i] = a.in[13][g * 1024 + i]; }
    __syncthreads();
    bf16_t* BtE = (bf16_t*)(ws + WS_BTE) + (size_t)g * 256 * 256;
    for (int i = tid; i < 256 * 128; i += 512) {
        const int row = i >> 7, col = (i & 127) * 2;
        unsigned w = 0u;
        if (row < 128) {
            const int n = row & 63, im = row >> 6, j = col >> 4, pp = col & 15, k = 15 - j;
            const float pr = pwr[n * 17 + k], pi = pwi[n * 17 + k];
            float v[2];
#pragma unroll
            for (int e = 0; e < 2; ++e) { const float br = bbr[n * 16 + pp + e], bi = bbi[n * 16 + pp + e]; v[e] = im ? (pr * bi + pi * br) : (pr * br - pi * bi); }
            w = pk2(v[0], v[1]);
        }
        *(unsigned*)(BtE + (size_t)row * 256 + col) = w;
    }
    for (int i = tid; i < 4096; i += 512) {
        const int d = i >> 8, p = (i >> 4) & 15, pp = i & 15;
        float s = 0.f;
        for (int n = 0; n < 64; ++n) {
            const float pr = pwr[n * 17 + d], pi = pwi[n * 17 + d], br = bbr[n * 16 + pp], bi = bbi[n * 16 + pp];
            const float xr = pr * br - pi * bi, xi = pr * bi + pi * br;
            s += cre[p * 64 + n] * xr - cim[p * 64 + n] * xi;
        }
        klag[i] = s;
    }
    __syncthreads();
    bf16_t* BtY = (bf16_t*)(ws + WS_BTY) + (size_t)g * 256 * ASK;
    for (int i = tid; i < 256 * (ASK / 2); i += 512) {
        const int row = i / (ASK / 2), col = (i % (ASK / 2)) * 2, t = row >> 4, p = row & 15;
        float v[2];
#pragma unroll
        for (int e = 0; e < 2; ++e) {
            const int cc = col + e;
            if (cc < 256) { const int j = cc >> 4, pp = cc & 15; v[e] = (t >= j) ? klag[(t - j) * 256 + p * 16 + pp] : 0.f; }
            else if (cc < 320) { const int n = cc - 256; v[e] = cre[p * 64 + n] * pwr[n * 17 + t + 1] - cim[p * 64 + n] * pwi[n * 17 + t + 1]; }
            else { const int n = cc - 320; v[e] = -(cre[p * 64 + n] * pwi[n * 17 + t + 1] + cim[p * 64 + n] * pwr[n * 17 + t + 1]); }
        }
        *(unsigned*)(BtY + (size_t)row * ASK + col) = pk2(v[0], v[1]);
    }
    __syncthreads();
}

__device__ __forceinline__ void p0_prologue(const Frame& F, const Args& a) {
    unsigned char* ws = a.ws;
    if (F.vcu < NG) p0_ssm_tables(F, a, F.vcu);
    LAS float* scr = (LAS float*)(F.lds + F.wave * 16384);
    const int gw = F.vcu * NWAVES + F.wave, NGW = F.G * NWAVES;
    if (gw >= 512 && gw < 512 + 768) p0_mod_item(a.in[1], a.in[3], (float*)(ws + WS_MODP), scr, gw - 512, F.lane);
    constexpr int I_IN = (DM / 64) * (INW / 32), I_GLU = (SSMW / 64) * (SSMW / 32), I_PS = (SSMW / 64) * (DM / 32), I_OUT = (DM / 64) * (DM / 32),
                  I_F1 = (DM / 64) * (DFF / 32), I_F2 = (DFF / 64) * (DM / 32);
    constexpr int NITEMS = I_IN + I_GLU + 2 * I_PS + I_OUT + I_F1 + I_F2;
    for (int it = gw; it < NITEMS; it += NGW) {
        int r = it;
        if (r < I_IN) { p0_transpose_item(a.in[6], INW, (bf16_t*)(ws + WS_WIN), DM, 0, scr, r, F.lane); continue; } r -= I_IN;
        if (r < I_GLU) { p0_transpose_item(a.in[15], SSMW, (bf16_t*)(ws + WS_WGLU), SSMW, 0, scr, r, F.lane); continue; } r -= I_GLU;
        if (r < I_PS) { p0_transpose_item(a.in[17], DM, (bf16_t*)(ws + WS_WPC), 2048, 0, scr, r, F.lane); continue; } r -= I_PS;
        if (r < I_PS) { p0_transpose_item(a.in[18], DM, (bf16_t*)(ws + WS_WPC), 2048, 1024, scr, r, F.lane); continue; } r -= I_PS;
        if (r < I_OUT) { p0_transpose_item(a.in[19], DM, (bf16_t*)(ws + WS_WOUT), DM, 0, scr, r, F.lane); continue; } r -= I_OUT;
        if (r < I_F1) { p0_transpose_item(a.in[21], DFF, (bf16_t*)(ws + WS_WF1), DM, 0, scr, r, F.lane); continue; } r -= I_F1;
        p0_transpose_item(a.in[22], DM, (bf16_t*)(ws + WS_WF2), DFF, 0, scr, r, F.lane);
    }
}

__device__ __forceinline__ void p1_mod_h(const Frame& F, const Args& a) {
    unsigned char* ws = a.ws;
    const float* modp = (const float*)(ws + WS_MODP); const float* bada = a.in[4];
    float* modf = (float*)(ws + WS_MODF);
    LAS float* gg1 = (LAS float*)F.lds;
    LAS float* sh1 = gg1 + 2048;
    const int b = F.vcu >> 5;
    for (int k = F.tid; k < 2048; k += 512) {
        float ssh = bada[k], ssc = bada[2048 + k];
#pragma unroll
        for (int ks = 0; ks < 16; ++ks) { ssh += modp[(size_t)(ks * 8 + b) * NMOD + k]; ssc += modp[(size_t)(ks * 8 + b) * NMOD + 2048 + k]; }
        gg1[k] = a.in[5][k] * (1.0f + ssc); sh1[k] = ssh;
    }
    if (F.tid < 384) {
        const int j = (F.vcu & 31) * 384 + F.tid;
        float s = bada[j];
#pragma unroll
        for (int ks = 0; ks < 16; ++ks) s += modp[(size_t)(ks * 8 + b) * NMOD + j];
        modf[(size_t)b * NMOD + j] = s;
    }
    __syncthreads();
    bf16_t* H = (bf16_t*)(ws + WS_H);
    for (int i = 0; i < 8; ++i) {
        const int m = F.vcu * 64 + F.wave * 8 + i;
        const f32x4* xr = (const f32x4*)(a.in[0] + (size_t)m * DM) + F.lane;
        f32x4 v[8]; float s = 0.f;
#pragma unroll
        for (int j = 0; j < 8; ++j) { v[j] = xr[64 * j]; s += (v[j][0] * v[j][0] + v[j][1] * v[j][1]) + (v[j][2] * v[j][2] + v[j][3] * v[j][3]); }
        const float rstd = 1.0f / sqrtf(wave_sum(s) * (1.0f / DM) + EPS);
        u32x2* o8 = (u32x2*)(H + (size_t)m * DM) + F.lane;
#pragma unroll
        for (int j = 0; j < 8; ++j) {
            const int k = (F.lane + 64 * j) * 4;
            const f32x4 gg = *(const LAS f32x4*)(gg1 + k), sh = *(const LAS f32x4*)(sh1 + k);
            const f32x4 hv = v[j] * rstd * gg + sh;
            u32x2 w; w.x = cvtpk(hv[0], hv[1]); w.y = cvtpk(hv[2], hv[3]);
            o8[64 * j] = w;
        }
    }
}

__device__ __forceinline__ void p3_kmean_item(const Frame& F, const Args& a, int item) {
    unsigned char* ws = a.ws;
    const int blk = item & 7, h = (item >> 3) & 7, b = item >> 6;
    const bf16_t* Kp = (const bf16_t*)(ws + WS_K) + ((size_t)(b * 2048 + blk * 256) * 1024 + h * 128);
    LAS float* red = (LAS float*)F.lds;
    const int dp = F.lane, kg = F.wave;
    float s0 = 0.f, s1 = 0.f;
    for (int kk = 0; kk < 32; ++kk) { const unsigned w = *(const unsigned*)(Kp + (size_t)(kg * 32 + kk) * 1024 + dp * 2); s0 += bflo(w); s1 += bfhi(w); }
    red[kg * 128 + dp * 2] = s0; red[kg * 128 + dp * 2 + 1] = s1;
    __syncthreads();
    if (F.tid < 128) {
        float s = 0.f;
#pragma unroll
        for (int q = 0; q < 8; ++q) s += red[q * 128 + F.tid];
        ((float*)(ws + WS_KMEAN))[(size_t)item * 128 + F.tid] = s * (1.0f / 256.0f);
    }
    __syncthreads();
}
__device__ __forceinline__ void p3_c2(const Frame& F, const Args& a) {
    unsigned char* ws = a.ws;
    const float* modf = (const float*)(ws + WS_MODF); const bf16_t* W1 = (const bf16_t*)(ws + WS_WF1);
    float* c2 = (float*)(ws + WS_C2);
    const int gw = F.vcu * NWAVES + F.wave;
    for (int i = 0; i < 4; ++i) {
        const int n = gw * 4 + i;
        float acc[8];
#pragma unroll
        for (int b = 0; b < 8; ++b) acc[b] = 0.f;
#pragma unroll 1
        for (int j = 0; j < 4; ++j) {
            const int k = F.lane * 8 + 512 * j;
            const u32x4 w = *(const u32x4*)(W1 + (size_t)n * DM + k);
            const float wf[8] = {bflo(w.x), bfhi(w.x), bflo(w.y), bfhi(w.y), bflo(w.z), bfhi(w.z), bflo(w.w), bfhi(w.w)};
#pragma unroll
            for (int b = 0; b < 8; ++b) {
                const f32x4 s0 = *(const f32x4*)(modf + (size_t)b * NMOD + 3 * DM + k), s1 = *(const f32x4*)(modf + (size_t)b * NMOD + 3 * DM + k + 4);
                acc[b] += (wf[0] * s0[0] + wf[1] * s0[1]) + (wf[2] * s0[2] + wf[3] * s0[3]) + (wf[4] * s1[0] + wf[5] * s1[1]) + (wf[6] * s1[2] + wf[7] * s1[3]);
            }
        }
#pragma unroll
        for (int b = 0; b < 8; ++b) { const float s = wave_sum(acc[b]); if (F.lane == 0) c2[(size_t)b * DFF + n] = s; }
    }
}

__device__ __forceinline__ int crow(int r, int hi) { return (r & 3) + 8 * (r >> 2) + 4 * hi; }
__device__ __forceinline__ unsigned off_b(unsigned row, unsigned ch) { return 256u * row + 16u * (ch ^ (((row & 3) << 2) | ((row >> 2) & 3))); }
__device__ __forceinline__ int t5_bucket(int n) {
    if (n < 16) return n;
    int b = 16;
    b += (n >= 19) + (n >= 21) + (n >= 24) + (n >= 27) + (n >= 31) + (n >= 35) + (n >= 40) + (n >= 46) + (n >= 52) + (n >= 59) + (n >= 67) + (n >= 77) + (n >= 87) + (n >= 99) + (n >= 113);
    return b;
}
constexpr int AL_K = 0, AL_V = 32768, AL_LUT = 65536, AL_SEL = AL_LUT + 3072, AL_KM = AL_SEL + 1024, AL_END = AL_KM + 3584;
__device__ __forceinline__ void attn_unit(const Frame& F, const Args& a, int b, int h, int own) {
    unsigned char* ws = a.ws;
    LAS unsigned char* L = F.lds;
    int lane_o = F.lane; asm volatile("" : "+v"(lane_o));
    const int lane = lane_o, w = F.wave, tid = w * 64 + lane, l31 = lane & 31, hh = lane >> 5;
    const bf16_t* Qg = (const bf16_t*)(ws + WS_Q) + ((size_t)(b * 2048 + own * 256) * 1024 + h * 128);
    const bf16_t* Kg = (const bf16_t*)(ws + WS_K) + ((size_t)(b * 2048) * 1024 + h * 128);
    const bf16_t* Vg = (const bf16_t*)(ws + WS_V) + ((size_t)(b * 2048) * 1024 + h * 128);
    LAS float* LUT = (LAS float*)(L + AL_LUT);
    LAS unsigned* SEL = (LAS unsigned*)(L + AL_SEL);
    LAS float* KM = (LAS float*)(L + AL_KM);
    {
        const float* km = (const float*)(ws + WS_KMEAN) + (size_t)((b * 8 + h) * 8) * 128;
        for (int i = tid; i < 7 * 128; i += 512) KM[i] = (i < own * 128) ? km[i] : 0.f;
        const float* rb = a.in[2];
        const float b31 = rb[31 * 8 + h];
        for (int j = tid; j < 767; j += 512) { const int rel = 511 - j; float v; if (rel < 0) v = -1e30f; else if (rel >= 128) v = 0.f; else v = (rb[t5_bucket(rel) * 8 + h] - b31) * LOG2E; LUT[j] = v; }
    }
    __syncthreads();
    if (tid < 256) {
        float gt[7];
#pragma unroll
        for (int n = 0; n < 7; ++n) gt[n] = 0.f;
        const bf16_t* qr = Qg + (size_t)tid * 1024;
#pragma unroll 2
        for (int d0 = 0; d0 < 128; d0 += 8) {
            const u32x4 qw = *(const u32x4*)(qr + d0);
            const float q0 = bflo(qw.x), q1 = bfhi(qw.x), q2 = bflo(qw.y), q3 = bfhi(qw.y), q4 = bflo(qw.z), q5 = bfhi(qw.z), q6 = bflo(qw.w), q7 = bfhi(qw.w);
#pragma unroll
            for (int n = 0; n < 7; ++n) {
                const f32x4 k0 = *(const LAS f32x4*)(KM + n * 128 + d0), k1 = *(const LAS f32x4*)(KM + n * 128 + d0 + 4);
                gt[n] += (q0 * k0[0] + q1 * k0[1]) + (q2 * k0[2] + q3 * k0[3]) + (q4 * k1[0] + q5 * k1[1]) + (q6 * k1[2] + q7 * k1[3]);
            }
        }
        int i0 = 0, i1 = 0, i2 = 0; float v0 = -INFINITY, v1 = -INFINITY, v2 = -INFINITY;
#pragma unroll
        for (int n = 0; n < 7; ++n) {
            const float gv = (n < own) ? gt[n] : -INFINITY;
            if (gv > v0) { v2 = v1; i2 = i1; v1 = v0; i1 = i0; v0 = gv; i0 = n; }
            else if (gv > v1) { v2 = v1; i2 = i1; v1 = gv; i1 = n; }
            else if (gv > v2) { v2 = gv; i2 = n; }
        }
        const unsigned sel3 = (1u << i0) | (1u << i1) | (1u << i2);
        SEL[tid] = (own <= 3) ? ((1u << own) - 1u) : sel3;
    }
    bf16x8 qf[8];
    { const bf16_t* qrow = Qg + (size_t)(w * 32 + l31) * 1024 + hh * 8;
#pragma unroll
      for (int s = 0; s < 8; ++s) qf[s] = *(const bf16x8*)(qrow + s * 16); }
    __syncthreads();
    const unsigned sel = SEL[w * 32 + l31];
    const int ntile = 4 * (own + 1);
    unsigned ssrc[2];
#pragma unroll
    for (int i = 0; i < 2; ++i) { const unsigned row = 4u * (2 * w + i) + (lane >> 4), slot = lane & 15, ch = slot ^ (((row & 3) << 2) | ((row >> 2) & 3)); ssrc[i] = row * 1024u + ch * 8u; }
    const unsigned sdw = (unsigned)w * 2048u;
#define ATT_STAGE(ti, buf) do { const int jb_ = own - ((ti) >> 2), t_ = (ti) & 3; const size_t base_ = (size_t)(jb_ * 256 + t_ * 64) * 1024; \
        _Pragma("unroll") for (int i = 0; i < 2; ++i) { \
            __builtin_amdgcn_global_load_lds((const unsigned*)(Kg + base_ + ssrc[i]), (LAS unsigned*)(L + AL_K + (buf) * 16384 + sdw + i * 1024), 16, 0, 0); \
            __builtin_amdgcn_global_load_lds((const unsigned*)(Vg + base_ + ssrc[i]), (LAS unsigned*)(L + AL_V + (buf) * 16384 + sdw + i * 1024), 16, 0, 0); } } while (0)
    ATT_STAGE(0, 0);
    __syncthreads();
    f32x16 o[4];
#pragma unroll
    for (int cb = 0; cb < 4; ++cb)
#pragma unroll
        for (int r = 0; r < 16; ++r) o[cb][r] = 0.f;
    float m_run = -1e30f, l_run = 0.f;
    const unsigned xr = ((l31 & 3) << 2) | ((l31 >> 2) & 3);
    const int tq = (lane & 15) >> 2, tp = lane & 3, tblk = (lane >> 4) & 1;
    unsigned kad[8], vba[4][2];
#pragma unroll
    for (int s = 0; s < 8; ++s) kad[s] = 256u * l31 + 16u * ((unsigned)(2 * s + hh) ^ xr);
#pragma unroll
    for (int cb = 0; cb < 4; ++cb)
#pragma unroll
        for (int t2 = 0; t2 < 2; ++t2)
            vba[cb][t2] = 256u * (8 * t2 + 4 * hh + tq) + 64u * (unsigned)(cb ^ tq) + 16u * (unsigned)((2 * tblk + (tp >> 1)) ^ (2 * t2 + hh)) + 8u * (tp & 1);
    const int qloc = w * 32 + l31;
#define ATT_TILE(BUF, TI) do { \
        const int ti_ = (TI), jb = own - (ti_ >> 2), t = ti_ & 3; \
        if (ti_ + 1 < ntile) ATT_STAGE(ti_ + 1, (BUF) ^ 1); \
        const float pen = (jb == own) ? 0.f : (((sel >> jb) & 1u) ? 0.f : -1e30f); \
        f32x16 p0, p1; \
        _Pragma("unroll") for (int r = 0; r < 16; ++r) { p0[r] = pen; p1[r] = pen; } \
        _Pragma("unroll") for (int s = 0; s < 8; ++s) { \
            const bf16x8 a0 = *(const LAS bf16x8*)(L + kad[s] + (AL_K + (BUF) * 16384)), a1 = *(const LAS bf16x8*)(L + kad[s] + (AL_K + (BUF) * 16384 + 8192)); \
            p0 = __builtin_amdgcn_mfma_f32_32x32x16_bf16(a0, qf[s], p0, 0, 0, 0); \
            p1 = __builtin_amdgcn_mfma_f32_32x32x16_bf16(a1, qf[s], p1, 0, 0, 0); } \
        __builtin_amdgcn_sched_barrier(0); \
        if (jb >= own - 1) { \
            const LAS float* lp = LUT + (511 - (own - jb) * 256 - qloc + 64 * t + 4 * hh); \
            _Pragma("unroll") for (int r = 0; r < 16; ++r) { const int ko = (r & 3) + 8 * (r >> 2); p0[r] += lp[ko]; p1[r] += lp[32 + ko]; } } \
        float mx = fmaxf(p0[0], p1[0]); \
        _Pragma("unroll") for (int r = 1; r < 16; ++r) mx = fmaxf(mx, fmaxf(p0[r], p1[r])); \
        mx = fmaxf(mx, __shfl_xor(mx, 32)); \
        const float mnew = fmaxf(m_run, mx); \
        const float alpha = fexp2(m_run - mnew); \
        m_run = mnew; \
        float ls = 0.f; \
        _Pragma("unroll") for (int r = 0; r < 16; ++r) { p0[r] = fexp2(p0[r] - mnew); p1[r] = fexp2(p1[r] - mnew); ls += p0[r] + p1[r]; } \
        ls += __shfl_xor(ls, 32); \
        l_run = l_run * alpha + ls; \
        if (!__all(alpha == 1.0f)) { \
            _Pragma("unroll") for (int r = 0; r < 16; ++r) { const float al = __shfl(alpha, crow(r, hh)); o[0][r] *= al; o[1][r] *= al; o[2][r] *= al; o[3][r] *= al; } } \
        bf16x8 pa[4]; \
        _Pragma("unroll") for (int s2 = 0; s2 < 2; ++s2) { \
            u32x4 w0, w1; \
            w0.x = cvtpk(p0[8 * s2 + 0], p0[8 * s2 + 1]); w0.y = cvtpk(p0[8 * s2 + 2], p0[8 * s2 + 3]); w0.z = cvtpk(p0[8 * s2 + 4], p0[8 * s2 + 5]); w0.w = cvtpk(p0[8 * s2 + 6], p0[8 * s2 + 7]); \
            w1.x = cvtpk(p1[8 * s2 + 0], p1[8 * s2 + 1]); w1.y = cvtpk(p1[8 * s2 + 2], p1[8 * s2 + 3]); w1.z = cvtpk(p1[8 * s2 + 4], p1[8 * s2 + 5]); w1.w = cvtpk(p1[8 * s2 + 6], p1[8 * s2 + 7]); \
            pa[s2] = __builtin_bit_cast(bf16x8, w0); pa[2 + s2] = __builtin_bit_cast(bf16x8, w1); } \
        __builtin_amdgcn_sched_barrier(0); \
        _Pragma("unroll") for (int cb = 0; cb < 4; ++cb) { \
            _Pragma("unroll") for (int ks = 0; ks < 4; ++ks) { \
                const v4i16_t x0 = __builtin_amdgcn_ds_read_tr16_b64_v4i16((LAS v4i16_t*)(L + vba[cb][0] + (AL_V + (BUF) * 16384 + 4096 * ks))); \
                const v4i16_t x1 = __builtin_amdgcn_ds_read_tr16_b64_v4i16((LAS v4i16_t*)(L + vba[cb][1] + (AL_V + (BUF) * 16384 + 4096 * ks))); \
                const bf16x8 vf = (bf16x8){x0[0], x0[1], x0[2], x0[3], x1[0], x1[1], x1[2], x1[3]}; \
                o[cb] = __builtin_amdgcn_mfma_f32_32x32x16_bf16(pa[ks], vf, o[cb], 0, 0, 0); } \
            __builtin_amdgcn_sched_barrier(0); } \
        __syncthreads(); \
    } while (0)
    for (int ti = 0; ti < ntile; ti += 2) { ATT_TILE(0, ti); ATT_TILE(1, ti + 1); }
#undef ATT_TILE
#undef ATT_STAGE
    bf16_t* Og = (bf16_t*)(ws + WS_ACAT) + ((size_t)(b * 2048 + own * 256 + w * 32) * 2048 + 1024 + h * 128);
#pragma unroll
    for (int r = 0; r < 16; ++r) {
        const int qr_ = crow(r, hh);
        const float li = frcp(__shfl(l_run, qr_));
#pragma unroll
        for (int cb = 0; cb < 4; ++cb) Og[(size_t)qr_ * 2048 + cb * 32 + l31] = (bf16_t)(cvtpk(o[cb][r] * li, 0.f) & 0xffffu);
    }
    __syncthreads();
}

__device__ __forceinline__ void p10_final(const Frame& F, const Args& a) {
    unsigned char* ws = a.ws;
    const float* ssq = (const float*)(ws + WS_SSQ2); const float* gf = a.in[23];
    for (int i = 0; i < 8; ++i) {
        const int m = F.vcu * 64 + F.wave * 8 + i;
        float s = (F.lane < 32) ? ssq[(size_t)m * 32 + F.lane] : 0.f;
        s = wave_sum(s);
        const float rstd = 1.0f / sqrtf(s * (1.0f / DM) + EPS);
        f32x4* xr = (f32x4*)(a.out + (size_t)m * DM) + F.lane;
#pragma unroll
        for (int j = 0; j < 8; ++j) { const f32x4 g4 = *((const f32x4*)gf + F.lane + 64 * j); xr[64 * j] = xr[64 * j] * rstd * g4; }
    }
}

__global__ void __launch_bounds__(NWAVES * 64, 2) mk_fwd(Args args) {
    extern __shared__ __attribute__((aligned(16))) unsigned char lds_raw[];
    Frame F;
    F.lds = (LAS unsigned char*)lds_raw;
    F.tid = threadIdx.x; F.lane = F.tid & 63; F.wave = __builtin_amdgcn_readfirstlane(F.tid >> 6);
    F.G = gridDim.x; { const int bx = blockIdx.x; F.vcu = (F.G % 8 == 0) ? (bx % 8) * (F.G / 8) + bx / 8 : bx; }
    unsigned char* ws = args.ws;
    volatile LAS unsigned* MISC = (volatile LAS unsigned*)(F.lds + MISC_OFF);
    for (int u = F.tid; u < (LDS_BYTES - LDSCTL_OFF) / 4; u += NWAVES * 64) ((LAS unsigned*)(F.lds + LDSCTL_OFF))[u] = 0u;
    __syncthreads();
    XcdBarrier bar; bar.bar = (unsigned*)(ws + WS_CTL) + CW_BAR; bar.x = 0; bar.st = nullptr;
    const int lo = args.ph_lo, hi = args.ph_hi;
    if (hi - lo > 1) bar = xcd_barrier_post((unsigned*)(ws + WS_CTL) + CW_BAR, MISC + 8);
#define IN(k) (lo <= (k) && (k) < hi)
#define SEAM(k) do { if (IN(k) && IN((k) + 1)) xcd_barrier(bar); } while (0)
    LAS unsigned char* ring = F.lds;
    const int cidx = (int)blockIdx.x;

    if (IN(0)) { p0_prologue(F, args); SEAM(0); }
    if (IN(1)) { p1_mod_h(F, args); SEAM(1); }
    if (IN(2)) {
        pg8::Gemm g{(const bf16_t*)(ws + WS_H), (const bf16_t*)(ws + WS_WIN), DM, DM, DM}; pg8::StaticOrder S; S.init(M, INW, F.G, cidx);
        EpiProj E{(bf16_t*)(ws + WS_AS), (bf16_t*)(ws + WS_Q), (bf16_t*)(ws + WS_K), (bf16_t*)(ws + WS_V), (bf16_t*)(ws + WS_SGA), (bf16_t*)(ws + WS_SGB)};
        pg8::gemm_phase<EpiProj, pg8::StaticOrder, true>(ring, g, S, E);
        SEAM(2);
    }
    if (IN(3)) {
        pg8::Gemm g{(const bf16_t*)(ws + WS_AS), (const bf16_t*)(ws + WS_BTE), ASK, 256, 256}; pg8::GroupOrder S{F.G, F.vcu};
        EpiScan E{(bf16_t*)(ws + WS_AS), (const float*)(ws + WS_A16)};
        pg8::gemm_phase<EpiScan, pg8::GroupOrder, false>(ring, g, S, E);
        __syncthreads();
        for (int it = F.vcu; it < 512; it += F.G) p3_kmean_item(F, args, it);
        p3_c2(F, args);
        SEAM(3);
    }
    if (IN(4)) {
        {
            pg8::Gemm g{(const bf16_t*)(ws + WS_AS), (const bf16_t*)(ws + WS_BTY), ASK, ASK, ASK}; pg8::GroupOrder S{F.G, F.vcu};
            EpiSsmOut E{(const bf16_t*)(ws + WS_AS), args.in[14], (bf16_t*)(ws + WS_YACT)};
            pg8::gemm_phase<EpiSsmOut, pg8::GroupOrder, true>(ring, g, S, E);
            __syncthreads();
        }
        for (int it = F.vcu; it < 256; it += F.G) {
            const int bh = it >> 2, s = it & 3;
            attn_unit(F, args, bh >> 3, bh & 7, 7 - s);
            attn_unit(F, args, bh >> 3, bh & 7, s);
        }
        SEAM(4);
    }
    if (IN(5)) {
        pg8::Gemm g{(const bf16_t*)(ws + WS_YACT), (const bf16_t*)(ws + WS_WGLU), SSMW, SSMW, SSMW}; pg8::StaticOrder S; S.init(M, SSMW, F.G, cidx);
        EpiGlu E{(const bf16_t*)(ws + WS_YACT), args.in[16], (bf16_t*)(ws + WS_ACAT)};
        pg8::gemm_phase<EpiGlu, pg8::StaticOrder, true>(ring, g, S, E);
        SEAM(5);
    }
    if (IN(6)) {
        pg8::Gemm g{(const bf16_t*)(ws + WS_ACAT), (const bf16_t*)(ws + WS_WPC), 2048, 2048, 2048}; pg8::StaticOrder S; S.init(M, DM, F.G, cidx);
        EpiMerge E{(const bf16_t*)(ws + WS_SGA), (const bf16_t*)(ws + WS_SGB), (bf16_t*)(ws + WS_MERGED)};
        pg8::gemm_phase<EpiMerge, pg8::StaticOrder, true>(ring, g, S, E);
        SEAM(6);
    }
    if (IN(7)) {
        pg8::Gemm g{(const bf16_t*)(ws + WS_MERGED), (const bf16_t*)(ws + WS_WOUT), DM, DM, DM}; pg8::StaticOrder S; S.init(M, DM, F.G, cidx);
        EpiRes1 E{args.in[0], (const float*)(ws + WS_MODF), args.in[20], args.out, (bf16_t*)(ws + WS_XS2), (float*)(ws + WS_SSQ1)};
        pg8::gemm_phase<EpiRes1, pg8::StaticOrder, true>(ring, g, S, E);
        SEAM(7);
    }
    if (IN(8)) {
        pg8::Gemm g{(const bf16_t*)(ws + WS_XS2), (const bf16_t*)(ws + WS_WF1), DM, DM, DM}; pg8::StaticOrder S; S.init(M, DFF, F.G, cidx);
        EpiFF1 E{(const float*)(ws + WS_SSQ1), (const float*)(ws + WS_C2), (bf16_t*)(ws + WS_FF)};
        pg8::gemm_phase<EpiFF1, pg8::StaticOrder, true>(ring, g, S, E);
        SEAM(8);
    }
    if (IN(9)) {
        pg8::Gemm g{(const bf16_t*)(ws + WS_FF), (const bf16_t*)(ws + WS_WF2), DFF, DFF, DFF}; pg8::StaticOrder S; S.init(M, DM, F.G, cidx);
        EpiRes2 E{(const float*)(ws + WS_MODF), args.out, (float*)(ws + WS_SSQ2)};
        pg8::gemm_phase<EpiRes2, pg8::StaticOrder, true>(ring, g, S, E);
        SEAM(9);
    }
    if (IN(10)) { p10_final(F, args); }
#undef IN
#undef SEAM
}

extern "C" void kernel_launch(void* const* d_in, const int* in_sizes, int n_in, void* d_out, int out_size, void* d_ws, size_t ws_size, hipStream_t stream) {
    static int grid = 0;
    if (grid == 0) {
        if (n_in != 24 || in_sizes[0] != M * DM || out_size != M * DM || ws_size < WS_END) { fprintf(stderr, "kernel_launch: unexpected shapes (n_in %d, in0 %d, out %d, ws %zu); nothing launched\n", n_in, n_in > 0 ? in_sizes[0] : -1, out_size, ws_size); grid = -1; return; }
        int dev = 0, cus = 0, per_cu = 0;
        if (hipGetDevice(&dev) != hipSuccess || hipDeviceGetAttribute(&cus, hipDeviceAttributeMultiprocessorCount, dev) != hipSuccess) { grid = -1; return; }
        if (hipFuncSetAttribute((const void*)mk_fwd, hipFuncAttributeMaxDynamicSharedMemorySize, LDS_BYTES) != hipSuccess) { fprintf(stderr, "kernel_launch: hipFuncSetAttribute failed\n"); grid = -1; return; }
        if (hipOccupancyMaxActiveBlocksPerMultiprocessor(&per_cu, (const void*)mk_fwd, NWAVES * 64, LDS_BYTES) != hipSuccess || per_cu < 1) { fprintf(stderr, "kernel_launch: occupancy query reports %d workgroups per CU\n", per_cu); }
        (void)hipGetLastError();
        grid = cus;
        if (grid != 256) fprintf(stderr, "kernel_launch: %d CUs; this kernel is written for 256\n", grid);
    }
    if (grid < 0) return;
    (void)hipMemsetAsync((char*)d_ws + WS_CTL, 0, CTL_ZERO_BYTES, stream);
    Args a{};
    for (int i = 0; i < 24; ++i) a.in[i] = (const float*)d_in[i];
    a.out = (float*)d_out; a.ws = (unsigned char*)d_ws;
    if (MK_N_LAUNCHES == 1) {
        a.ph_lo = 0; a.ph_hi = N_PHASES;
        hipLaunchKernelGGL(mk_fwd, dim3(grid), dim3(NWAVES * 64), LDS_BYTES, stream, a);
    } else {
        for (int li = 0; li < N_PHASES; ++li) { a.ph_lo = li; a.ph_hi = li + 1; hipLaunchKernelGGL(mk_fwd, dim3(grid), dim3(NWAVES * 64), LDS_BYTES, stream, a); }
    }
}
```
